# Optimizing an MI355X kernel written in HIP

```python
import math
import jax, jax.numpy as jnp
from jax import lax
import numpy as np

D_MODEL = 1024
BATCH = 4
SEQ = 4096
DEPTH = 1

CHUNK = 64
EPS = 1e-6
NEG_INF = -1e30

BRANCH_WIDTH = D_MODEL // 2
N_BRANCH = 3

A_HEADS = 8
A_HEAD_DIM = BRANCH_WIDTH // A_HEADS
A_LEFT_CHUNKS = 8
A_BAND = A_LEFT_CHUNKS + 1
REL_CLIP = 128

B_HEADS = 4
B_HEAD_DIM = BRANCH_WIDTH // B_HEADS
CONV_WIDTH = 4

MEM_TOKENS = 256
M_HEADS = 4
M_HEAD_DIM = BRANCH_WIDTH // M_HEADS

PEER_HEADS = 8
PEER_NKEYS = 128
PEER_EXPERTS = PEER_NKEYS * PEER_NKEYS
PEER_KEY_DIM = 256
PEER_HALF = PEER_KEY_DIM // 2
PEER_TOPK = 16
PEER_BLOCK = 128

IN_SPLITS = (
    BRANCH_WIDTH, BRANCH_WIDTH, BRANCH_WIDTH,
    BRANCH_WIDTH, BRANCH_WIDTH, BRANCH_WIDTH,
    BRANCH_WIDTH,
    B_HEADS, B_HEADS,
    BRANCH_WIDTH,
    N_BRANCH * D_MODEL,
)
IN_COLS = sum(IN_SPLITS)

kernel_name = "hybrid_chunkattn_gdn_memxattn_peer"


def rmsnorm(x, g):
    xf = x.astype(jnp.float32)
    y = xf * lax.rsqrt(jnp.mean(xf * xf, axis=-1, keepdims=True) + EPS)
    return (y * g.astype(jnp.float32)).astype(x.dtype)


def l2norm(x):
    xf = x.astype(jnp.float32)
    return xf * lax.rsqrt(jnp.sum(xf * xf, axis=-1, keepdims=True) + EPS)


def chunked_rel_attention(q, k, v, rel_bias):
    B_, S_, H, hd = q.shape
    nc = S_ // CHUNK
    qc = q.reshape(B_, nc, CHUNK, H, hd)
    kc = k.reshape(B_, nc, CHUNK, H, hd)
    vc = v.reshape(B_, nc, CHUNK, H, hd)
    pad = ((0, 0), (A_LEFT_CHUNKS, 0), (0, 0), (0, 0), (0, 0))
    kp = jnp.pad(kc, pad)
    vp = jnp.pad(vc, pad)
    kband = jnp.concatenate([kp[:, j:j + nc] for j in range(A_BAND)], axis=2)
    vband = jnp.concatenate([vp[:, j:j + nc] for j in range(A_BAND)], axis=2)
    s = jnp.einsum('bcqhd,bckhd->bhcqk', qc, kband).astype(jnp.float32) * (hd ** -0.5)
    qpos = jnp.arange(CHUNK)
    kpos = jnp.arange(A_BAND * CHUNK) - A_LEFT_CHUNKS * CHUNK
    rel = qpos[:, None] - kpos[None, :]
    idx = jnp.clip(rel, -REL_CLIP, REL_CLIP) + REL_CLIP
    bias = rel_bias[:, idx].astype(jnp.float32)
    kchunk = jnp.arange(nc)[:, None] - A_LEFT_CHUNKS + (jnp.arange(A_BAND * CHUNK) // CHUNK)[None, :]
    valid = kchunk >= 0
    s = s + bias[None, :, None, :, :]
    s = jnp.where(valid[None, None, :, None, :], s, NEG_INF)
    p = jax.nn.softmax(s, axis=-1).astype(v.dtype)
    o = jnp.einsum('bhcqk,bckhd->bcqhd', p, vband)
    return o.reshape(B_, S_, H * hd)


def causal_conv_silu(x, w):
    y = lax.conv_general_dilated(
        x, w.astype(x.dtype), window_strides=(1,), padding=[(CONV_WIDTH - 1, 0)],
        dimension_numbers=('NWC', 'WIO', 'NWC'), feature_group_count=x.shape[-1])
    return jax.nn.silu(y)


def gated_delta_rule(q, k, v, g, beta):
    f32 = jnp.float32
    B_, S_, H, dk = q.shape
    dv = v.shape[-1]
    nc = S_ // CHUNK

    def to_chunks(t):
        return t.astype(f32).reshape(B_, nc, CHUNK, H, -1).transpose(0, 3, 1, 2, 4)

    qc, kc, vc = to_chunks(q), to_chunks(k), to_chunks(v)
    gc = jnp.cumsum(g.astype(f32).reshape(B_, nc, CHUNK, H).transpose(0, 3, 1, 2), axis=-1)
    bc = beta.astype(f32).reshape(B_, nc, CHUNK, H).transpose(0, 3, 1, 2)
    tri_incl = jnp.tril(jnp.ones((CHUNK, CHUNK), dtype=bool))
    tri_strict = jnp.tril(jnp.ones((CHUNK, CHUNK), dtype=bool), k=-1)
    gamma = jnp.exp(jnp.where(tri_incl, gc[..., :, None] - gc[..., None, :], -jnp.inf))
    kk = jnp.einsum('bhnid,bhnjd->bhnij', kc, kc)
    a_strict = jnp.where(tri_strict, bc[..., :, None] * kk * gamma, 0.0)
    eye = jnp.eye(CHUNK, dtype=f32)
    rhs = jnp.concatenate([vc * bc[..., None], kc * (bc * jnp.exp(gc))[..., None]], axis=-1)
    sol = lax.linalg.triangular_solve(eye + a_strict, rhs, left_side=True, lower=True,
                                      unit_diagonal=True)
    u, w = sol[..., :dv], sol[..., dv:]
    qk = jnp.where(tri_incl, jnp.einsum('bhnid,bhnjd->bhnij', qc, kc) * gamma, 0.0)
    q_dec = qc * jnp.exp(gc)[..., None]
    k_dec = kc * jnp.exp(gc[..., -1:] - gc)[..., None]
    g_last = jnp.exp(gc[..., -1])
    xs = (jnp.moveaxis(u, 2, 0), jnp.moveaxis(w, 2, 0), jnp.moveaxis(qk, 2, 0),
          jnp.moveaxis(q_dec, 2, 0), jnp.moveaxis(k_dec, 2, 0), jnp.moveaxis(g_last, 2, 0))

    def step(state, inp):
        u_c, w_c, qk_c, qd_c, kd_c, gl_c = inp
        v_new = u_c - jnp.einsum('bhcd,bhde->bhce', w_c, state)
        o_c = jnp.einsum('bhcd,bhde->bhce', qd_c, state) + jnp.einsum('bhij,bhje->bhie', qk_c, v_new)
        state = state * gl_c[..., None, None] + jnp.einsum('bhcd,bhce->bhde', kd_c, v_new)
        return state, o_c

    s0 = jnp.zeros((B_, H, dk, dv), f32)
    _, o = lax.scan(step, s0, xs)
    return o.transpose(1, 0, 3, 2, 4).reshape(B_, S_, H, dv)


def memory_cross_attention(qm, mem, g_mem, w_mem_kv, gq, gk):
    B_, S_, _ = qm.shape
    M_ = mem.shape[1]
    kv = rmsnorm(mem, g_mem) @ w_mem_kv
    km, vm = jnp.split(kv, 2, axis=-1)
    q = rmsnorm(qm.reshape(B_, S_, M_HEADS, M_HEAD_DIM), gq)
    k = rmsnorm(km.reshape(B_, M_, M_HEADS, M_HEAD_DIM), gk)
    v = vm.reshape(B_, M_, M_HEADS, M_HEAD_DIM)
    s = jnp.einsum('bshd,bmhd->bhsm', q, k).astype(jnp.float32) * (M_HEAD_DIM ** -0.5)
    p = jax.nn.softmax(s, axis=-1).astype(v.dtype)
    return jnp.einsum('bhsm,bmhd->bshd', p, v).reshape(B_, S_, M_HEADS * M_HEAD_DIM)


def peer(xn, w_q, sub_keys, expert_u, expert_v):
    B_, S_, D = xn.shape
    T = B_ * S_
    xt = xn.reshape(T, D)
    qry = (xt @ w_q).reshape(T, PEER_HEADS, 2, PEER_HALF)
    sc = jnp.einsum('thpc,pnc->thpn', qry, sub_keys).astype(jnp.float32)
    s1, i1 = lax.top_k(sc[:, :, 0], PEER_TOPK)
    s2, i2 = lax.top_k(sc[:, :, 1], PEER_TOPK)
    cand_s = (s1[..., :, None] + s2[..., None, :]).reshape(T, PEER_HEADS, PEER_TOPK * PEER_TOPK)
    cand_i = (i1[..., :, None] * PEER_NKEYS + i2[..., None, :]).reshape(T, PEER_HEADS, PEER_TOPK * PEER_TOPK)
    top_s, pos = lax.top_k(cand_s, PEER_TOPK)
    eidx = jnp.take_along_axis(cand_i, pos, axis=-1)
    gate = jax.nn.softmax(top_s, axis=-1).astype(xn.dtype)
    nb = T // PEER_BLOCK

    def block(args):
        xb, eb, gb = args
        u = expert_u[eb]
        v = expert_v[eb]
        a = jnp.einsum('thkd,td->thk', u, xb)
        return jnp.einsum('thk,thkd->td', gb * jax.nn.gelu(a, approximate=False), v)

    y = lax.map(block, (xt.reshape(nb, PEER_BLOCK, D),
                        eidx.reshape(nb, PEER_BLOCK, PEER_HEADS, PEER_TOPK),
                        gate.reshape(nb, PEER_BLOCK, PEER_HEADS, PEER_TOPK)))
    return y.reshape(B_, S_, D)


def setup_inputs(seed: int = 0) -> dict:
    key = jax.random.key(seed)
    ks = jax.random.split(key, 24)
    f32 = jnp.float32
    L, D = DEPTH, D_MODEL

    def nrm(k, shape, scale):
        return jax.random.normal(k, shape, f32) * scale

    def gain(k, n):
        return 1.0 + 0.05 * jax.random.normal(k, (L, n), f32)

    dt = jnp.exp(jax.random.uniform(ks[8], (L, B_HEADS), f32, math.log(1e-3), math.log(1e-1)))
    dt_bias = dt + jnp.log(-jnp.expm1(-dt))
    return {
        "x": nrm(ks[0], (BATCH, SEQ, D), 1.0),
        "mem": nrm(ks[1], (BATCH, MEM_TOKENS, D), 1.0),
        "g_mix_norm": gain(ks[2], D),
        "w_in": nrm(ks[3], (L, D, IN_COLS), D ** -0.5),
        "a_q_norm": gain(ks[4], A_HEAD_DIM),
        "a_k_norm": gain(ks[5], A_HEAD_DIM),
        "a_rel_bias": nrm(ks[6], (L, A_HEADS, 2 * REL_CLIP + 1), 0.1),
        "b_conv": nrm(ks[7], (L, CONV_WIDTH, 1, 3 * BRANCH_WIDTH), CONV_WIDTH ** -0.5),
        "b_a_log": jnp.log(jax.random.uniform(ks[9], (L, B_HEADS), f32, 1.0, 16.0)),
        "b_dt_bias": dt_bias,
        "b_out_norm": gain(ks[10], B_HEAD_DIM),
        "g_mem_norm": gain(ks[11], D),
        "w_mem_kv": nrm(ks[12], (L, D, 2 * BRANCH_WIDTH), D ** -0.5),
        "m_q_norm": gain(ks[13], M_HEAD_DIM),
        "m_k_norm": gain(ks[14], M_HEAD_DIM),
        "w_branch": nrm(ks[15], (L, N_BRANCH, BRANCH_WIDTH, D), BRANCH_WIDTH ** -0.5),
        "w_out": nrm(ks[16], (L, D, D), D ** -0.5),
        "g_ffn_norm": gain(ks[17], D),
        "w_peer_q": nrm(ks[18], (L, D, PEER_HEADS * PEER_KEY_DIM), D ** -0.5),
        "peer_sub_keys": nrm(ks[19], (L, 2, PEER_NKEYS, PEER_HALF), PEER_HALF ** -0.5),
        "peer_u": nrm(ks[20], (L, PEER_EXPERTS, D), D ** -0.5),
        "peer_v": nrm(ks[21], (L, PEER_EXPERTS, D), PEER_HEADS ** -0.5),
    }


def reference(x, mem, g_mix_norm, w_in, a_q_norm, a_k_norm, a_rel_bias, b_conv, b_a_log,
              b_dt_bias, b_out_norm, g_mem_norm, w_mem_kv, m_q_norm, m_k_norm, w_branch,
              w_out, g_ffn_norm, w_peer_q, peer_sub_keys, peer_u, peer_v):
    f32 = jnp.float32
    B_, S_, _ = x.shape
    offsets = [int(o) for o in np.cumsum(IN_SPLITS)[:-1]]
    h = x
    for l in range(DEPTH):
        n = rmsnorm(h, g_mix_norm[l])
        proj = n @ w_in[l]
        (qa, ka, va, qb, kb, vb, zb, beta_raw, alpha_raw, qm, gate_raw) = jnp.split(proj, offsets, axis=-1)

        qa = rmsnorm(qa.reshape(B_, S_, A_HEADS, A_HEAD_DIM), a_q_norm[l])
        ka = rmsnorm(ka.reshape(B_, S_, A_HEADS, A_HEAD_DIM), a_k_norm[l])
        va = va.reshape(B_, S_, A_HEADS, A_HEAD_DIM)
        o_a = chunked_rel_attention(qa, ka, va, a_rel_bias[l])

        qkv = causal_conv_silu(jnp.concatenate([qb, kb, vb], axis=-1), b_conv[l])
        qb, kb, vb = jnp.split(qkv, 3, axis=-1)
        qb = l2norm(qb.reshape(B_, S_, B_HEADS, B_HEAD_DIM)) * (B_HEAD_DIM ** -0.5)
        kb = l2norm(kb.reshape(B_, S_, B_HEADS, B_HEAD_DIM))
        vb = vb.reshape(B_, S_, B_HEADS, B_HEAD_DIM)
        beta = jax.nn.sigmoid(beta_raw.astype(f32))
        g = -jnp.exp(b_a_log[l].astype(f32)) * jax.nn.softplus(alpha_raw.astype(f32) + b_dt_bias[l].astype(f32))
        o_b = gated_delta_rule(qb, kb, vb, g, beta).astype(x.dtype)
        o_b = rmsnorm(o_b, b_out_norm[l]) * jax.nn.silu(zb.reshape(B_, S_, B_HEADS, B_HEAD_DIM))
        o_b = o_b.reshape(B_, S_, BRANCH_WIDTH)

        o_m = memory_cross_attention(qm, mem, g_mem_norm[l], w_mem_kv[l], m_q_norm[l], m_k_norm[l])

        branches = jnp.stack([o_a, o_b, o_m], axis=2)
        y = jnp.einsum('bsnw,nwd->bsnd', branches, w_branch[l])
        gates = jax.nn.sigmoid(gate_raw.reshape(B_, S_, N_BRANCH, D_MODEL))
        h = h + jnp.einsum('bsnd,bsnd->bsd', gates, y) @ w_out[l]

        h = h + peer(rmsnorm(h, g_ffn_norm[l]), w_peer_q[l], peer_sub_keys[l], peer_u[l], peer_v[l])
    return h
```

```cpp
#define MK_N_LAUNCHES 11
#include <hip/hip_runtime.h>
#include <cstdio>
#include <cstdint>

#define LAS __attribute__((address_space(3)))
#define GAS __attribute__((address_space(1)))
typedef unsigned short bf16;
typedef short bf16x8 __attribute__((ext_vector_type(8)));
typedef float f32x4 __attribute__((ext_vector_type(4)));
typedef float f32x2 __attribute__((ext_vector_type(2)));
typedef unsigned u32x4 __attribute__((ext_vector_type(4)));
typedef unsigned u32x2 __attribute__((ext_vector_type(2)));
typedef GAS unsigned gu32;

constexpr int D = 1024, NB = 4, SEQ = 4096, T = NB * SEQ, CH = 64, NCH = SEQ / CH;
constexpr int INC = 7176, NPA = 4096, NG = 3072;
constexpr int MEMT = 256;
constexpr float EPS = 1e-6f;
constexpr int NEXP = 16384;

constexpr size_t MiB = 1u << 20;
constexpr size_t WS_CTL = 0, CTL_ZERO_BYTES = 1 * MiB;
constexpr size_t WS_WIN = 1 * MiB;
constexpr size_t WS_WKV = 15 * MiB;
constexpr size_t WS_WBR = 17 * MiB;
constexpr size_t WS_WOUT = 20 * MiB;
constexpr size_t WS_WQ = 22 * MiB;
constexpr size_t WS_SK = 26 * MiB;
constexpr size_t WS_BG = 26 * MiB + 512 * 1024;
constexpr size_t WS_MEMN = 27 * MiB;
constexpr size_t WS_KVM = 29 * MiB;
constexpr size_t WS_GL = 31 * MiB;
constexpr size_t WS_PROJ = 32 * MiB;
constexpr size_t WS_PREP = 160 * MiB;
constexpr size_t WS_PU = WS_PREP, WS_PW = WS_PREP + 16 * MiB, WS_PQD = WS_PREP + 32 * MiB, WS_PKDT = WS_PREP + 48 * MiB, WS_PQK = WS_PREP + 64 * MiB;
constexpr size_t WS_OB1 = 232 * MiB;
constexpr size_t WS_GATES = 32 * MiB;
constexpr size_t WS_MERGED = 128 * MiB;
constexpr size_t WS_HB = 32 * MiB;
constexpr size_t WS_QRY = 64 * MiB;
constexpr size_t WS_EIDX = 128 * MiB;
constexpr size_t WS_GW = 136 * MiB;
constexpr size_t WS_TU = 160 * MiB;
constexpr size_t WS_TV = 192 * MiB;
constexpr size_t WS_END = 256 * MiB;
constexpr size_t DO_XN = 0, DO_OA = 32 * MiB, DO_OM = 48 * MiB;
constexpr int CW_TMO = 0, CW_BAR = 4096, CW_QUEUE = 8192, CW_ROWSS = 65536;

constexpr int RING_BYTES = 131072;
constexpr int LDS_BYTES = 147456;
constexpr int MISC_OFF = LDS_BYTES - 512;

#define RLX_AGENT __ATOMIC_RELAXED, __HIP_MEMORY_SCOPE_AGENT
#define LDS_WAIT() asm volatile("s_waitcnt lgkmcnt(0)" ::: "memory")
#define VM_WAIT() asm volatile("s_waitcnt vmcnt(0)" ::: "memory")
__device__ __forceinline__ unsigned f2bf(float f) { unsigned u = __builtin_bit_cast(unsigned, f); return (u + 0x7fffu + ((u >> 16) & 1u)) >> 16; }
__device__ __forceinline__ unsigned pk2(float lo, float hi) { return f2bf(lo) | (f2bf(hi) << 16); }
__device__ __forceinline__ float bflo(unsigned w) { return __builtin_bit_cast(float, w << 16); }
__device__ __forceinline__ float bfhi(unsigned w) { return __builtin_bit_cast(float, w & 0xffff0000u); }
__device__ __forceinline__ float bf2f(bf16 h) { return __builtin_bit_cast(float, (unsigned)h << 16); }
__device__ __forceinline__ void unpack8(u32x4 w, float (&v)[8]) { v[0] = bflo(w.x); v[1] = bfhi(w.x); v[2] = bflo(w.y); v[3] = bfhi(w.y); v[4] = bflo(w.z); v[5] = bfhi(w.z); v[6] = bflo(w.w); v[7] = bfhi(w.w); }
__device__ __forceinline__ u32x4 pack8(const float (&v)[8]) { u32x4 w; w.x = pk2(v[0], v[1]); w.y = pk2(v[2], v[3]); w.z = pk2(v[4], v[5]); w.w = pk2(v[6], v[7]); return w; }
__device__ __forceinline__ float wave_sum(float v) {
#pragma unroll
    for (int o = 1; o < 64; o <<= 1) v += __shfl_xor(v, o);
    return v;
}
__device__ __forceinline__ float sigmoidf_(float x) { return 1.f / (1.f + __expf(-x)); }
__device__ __forceinline__ float siluf_(float x) { return x / (1.f + __expf(-x)); }
#define MFMA16(a, b, c) __builtin_amdgcn_mfma_f32_16x16x32_bf16((a), (b), (c), 0, 0, 0)

namespace pg8 {
constexpr int BM = 256, BK = 64, HALF = 128, HTB = HALF * BK * 2  , STAGE_BYTES = 8 * HTB, NXCD = 8, WGM = 8;

__host__ __device__ __forceinline__ int lds_byte(int r, int c) { const int st = (r >> 4) * 2 + (c >> 5), rr = r & 15, cc = c & 31, ob = rr * 64 + cc * 2; return st * 1024 + (ob ^ (((ob >> 9) & 1) << 5)); }
__host__ __device__ __forceinline__ void stage_rc(int b, int& R, int& C) { const int st = b / 1024, sb = b % 1024, swz = sb ^ (((sb >> 9) & 1) << 5); R = (st >> 1) * 16 + swz / 64; C = (st & 1) * 32 + (swz % 64) / 2; }
__host__ __device__ __forceinline__ int perm32(int rho) { const int n = rho >> 4, i = rho & 15; return 8 * (i >> 2) + 4 * n + (i & 3); }

struct Unit { int pm, pn, z; const char* a; const char* b; };
struct Gemm { int lda, ldb, K; };

__device__ __forceinline__ bool tile_of(long L, int nM, int nN, int& pm, int& pn) {
    const int nwg = nM * nN; if (L >= nwg) return false;
    int wgid = (int)L; { const int q = nwg / NXCD, r = nwg % NXCD, xcd = wgid % NXCD, off = wgid / NXCD; wgid = (xcd < r ? xcd * (q + 1) : r * (q + 1) + (xcd - r) * q) + off; }
    const int nig = WGM * nN, gid = wgid / nig, fm = gid * WGM, gsz = (nM - fm) < WGM ? (nM - fm) : WGM;
    pm = fm + ((wgid % nig) % gsz); pn = (wgid % nig) / gsz; return true;
}

__device__ __forceinline__ unsigned cvt_pk_bf16(float lo, float hi) { unsigned r; asm volatile("v_cvt_pk_bf16_f32 %0, %1, %2" : "=v"(r) : "v"(lo), "v"(hi)); return r; }

template <class Epi, class Sched, bool ALIGN_EPI = true>
__device__ __forceinline__ void gemm_phase(LAS unsigned char* lds, const Gemm g, const Sched& S, const Epi& E) {
    const int tid = threadIdx.x, wid = __builtin_amdgcn_readfirstlane(tid >> 6), lane = tid & 63, wr = wid >> 2, wc = wid & 3, fr = lane & 15, fq = lane >> 4;
    const int K = g.K, nt = K / BK;
    unsigned voffA[2], voffB[2];
#pragma unroll
    for (int i = 0; i < 2; ++i) { int R, C; stage_rc(tid * 16 + i * 8192, R, C); const int Rb = (R & ~31) + perm32(R & 31);
        voffA[i] = (unsigned)(R * g.lda + C) * 2u; voffB[i] = (unsigned)(Rb * g.ldb + C) * 2u; }
    const size_t kstep = (size_t)(BK * 2);
    const size_t hA = (size_t)HALF * g.lda * 2, hB = (size_t)HALF * g.ldb * 2;
    const unsigned ldsw = (unsigned)wid * 1024u;
    const int aoff = lds_byte(wr * 64 + fr, fq * 8), boff = lds_byte(wc * 32 + fr, fq * 8);
#define PG8_SA(b, h) (((b) * 2 + (h)) * HTB)
#define PG8_SB(b, h) ((4 + (b) * 2 + (h)) * HTB)
#define PG8_STAGE(bufoff, gbase, voff) do { _Pragma("unroll") for (int _i = 0; _i < 2; ++_i) \
        __builtin_amdgcn_global_load_lds((const unsigned*)((const char*)(gbase) + (voff)[_i]), (LAS unsigned*)(lds + (bufoff) + ldsw + _i * 8192), 16, 0, 0); } while (0)
#define PG8_LDA(dst, b, h) do { _Pragma("unroll") for (int m = 0; m < 4; ++m) _Pragma("unroll") for (int k = 0; k < 2; ++k) dst[m][k] = *(const LAS bf16x8*)(lds + PG8_SA(b, h) + aoff + m * 2048 + k * 1024); } while (0)
#define PG8_LDB(dst, b, h) do { _Pragma("unroll") for (int n = 0; n < 2; ++n) _Pragma("unroll") for (int k = 0; k < 2; ++k) dst[n][k] = *(const LAS bf16x8*)(lds + PG8_SB(b, h) + boff + n * 2048 + k * 1024); } while (0)
#define PG8_MMA(ai, bj, At, Bt) do { __builtin_amdgcn_s_setprio(1); _Pragma("unroll") for (int m = 0; m < 4; ++m) _Pragma("unroll") for (int n = 0; n < 2; ++n) _Pragma("unroll") for (int k = 0; k < 2; ++k) \
        acc[ai][bj][m][n] = __builtin_amdgcn_mfma_f32_16x16x32_bf16(Bt[n][k], At[m][k], acc[ai][bj][m][n], 0, 0, 0); __builtin_amdgcn_s_setprio(0); } while (0)
#define PG8_WAIT_V(n) asm volatile("s_waitcnt vmcnt(" #n ")" ::: "memory")
#define PG8_WAIT_L(n) asm volatile("s_waitcnt lgkmcnt(" #n ")" ::: "memory")
#define PG8_BAR __builtin_amdgcn_s_barrier()
#define PG8_SCHED __builtin_amdgcn_sched_barrier(0)
    Unit cur, nxt; int ui = 0;
    if (!S.next(0, cur)) return;
    f32x4 acc[2][2][4][2];
#pragma unroll
    for (int a = 0; a < 2; ++a)
#pragma unroll
        for (int b = 0; b < 2; ++b)
#pragma unroll
            for (int m = 0; m < 4; ++m)
#pragma unroll
                for (int n = 0; n < 2; ++n) acc[a][b][m][n] = (f32x4){0.f, 0.f, 0.f, 0.f};
    bf16x8 At[4][2], B0[2][2], B1[2][2];
    const char* cA = cur.a; const char* cB = cur.b;
    PG8_STAGE(PG8_SB(0, 0), cB, voffB); PG8_STAGE(PG8_SB(0, 1), cB + hB, voffB); PG8_STAGE(PG8_SA(0, 0), cA, voffA); PG8_STAGE(PG8_SA(0, 1), cA + hA, voffA);
    if (wr == 1) PG8_BAR;
    PG8_WAIT_V(2); PG8_BAR;
    PG8_STAGE(PG8_SB(1, 0), cB + kstep, voffB); PG8_STAGE(PG8_SA(1, 0), cA + kstep, voffA); PG8_STAGE(PG8_SB(1, 1), cB + hB + kstep, voffB);
    PG8_WAIT_V(6); PG8_BAR;
    for (;;) {
        const bool has_next = S.next(ui + 1, nxt);
        const char* nA = has_next ? nxt.a : cA; const char* nB = has_next ? nxt.b : cB;
        for (int t = 0; t < nt; t += 2) {
            const bool last = (t == nt - 2);
            const char* a1 = cA + (size_t)(t + 1) * kstep;
            const char* a2 = last ? nA : cA + (size_t)(t + 2) * kstep; const char* b2 = last ? nB : cB + (size_t)(t + 2) * kstep;
            const char* a3 = a2 + kstep; const char* b3 = b2 + kstep;
            PG8_LDB(B0, 0, 0); PG8_LDB(B1, 0, 1); PG8_SCHED; PG8_LDA(At, 0, 0); PG8_STAGE(PG8_SA(1, 1), a1 + hA, voffA);
            PG8_WAIT_V(8); PG8_WAIT_L(0); PG8_BAR; PG8_MMA(0, 0, At, B0); PG8_MMA(0, 1, At, B1); PG8_BAR; PG8_SCHED;
            PG8_LDA(At, 0, 1); PG8_STAGE(PG8_SB(0, 0), b2, voffB); PG8_STAGE(PG8_SB(0, 1), b2 + hB, voffB); PG8_STAGE(PG8_SA(0, 0), a2, voffA);
            PG8_WAIT_V(8); PG8_WAIT_L(0); PG8_BAR; PG8_MMA(1, 0, At, B0); PG8_MMA(1, 1, At, B1); PG8_BAR; PG8_SCHED;
            PG8_LDB(B0, 1, 0); PG8_LDB(B1, 1, 1); PG8_SCHED; PG8_LDA(At, 1, 0); PG8_STAGE(PG8_SA(0, 1), a2 + hA, voffA);
            PG8_WAIT_V(8); PG8_WAIT_L(0); PG8_BAR; PG8_MMA(0, 0, At, B0); PG8_MMA(0, 1, At, B1); PG8_BAR; PG8_SCHED;
            PG8_LDA(At, 1, 1); PG8_STAGE(PG8_SB(1, 0), b3, voffB); PG8_STAGE(PG8_SB(1, 1), b3 + hB, voffB); PG8_STAGE(PG8_SA(1, 0), a3, voffA);
            PG8_WAIT_V(8); PG8_WAIT_L(0); PG8_BAR; PG8_MMA(1, 0, At, B0); PG8_MMA(1, 1, At, B1); PG8_BAR; PG8_SCHED;
        }
        if constexpr (ALIGN_EPI) { if (wr == 0) PG8_BAR; }
        E(acc, cur, wr, wc, fr, fq);
        if (!has_next) break;
#pragma unroll
        for (int a = 0; a < 2; ++a)
#pragma unroll
            for (int b = 0; b < 2; ++b)
#pragma unroll
                for (int m = 0; m < 4; ++m)
#pragma unroll
                    for (int n = 0; n < 2; ++n) acc[a][b][m][n] = (f32x4){0.f, 0.f, 0.f, 0.f};
        cur = nxt; cA = nA; cB = nB; ++ui;
        if constexpr (ALIGN_EPI) { if (wr == 1) PG8_BAR; }
    }
    PG8_WAIT_V(0);
    if constexpr (!ALIGN_EPI) { if (wr == 0) PG8_BAR; }
    PG8_BAR;
#undef PG8_SA
#undef PG8_SB
#undef PG8_STAGE
#undef PG8_LDA
#undef PG8_LDB
#undef PG8_MMA
#undef PG8_WAIT_V
#undef PG8_WAIT_L
#undef PG8_BAR
#undef PG8_SCHED
}
}

#define XB_TMO      128
#define XB_XCNT(j)  (256  + 64 * (j))
#define XB_XSUB(j)  (1280 + 64 * (j))
#define XB_XGEN(j)  (2304 + 64 * (j))
#define XB_TOP      3328
#define XB_TOPGEN   3392
#define XCD_BAR_WORDS 3456
#define XB_SPIN_CAP (1u << 20)

__device__ __forceinline__ unsigned xb_ld(unsigned* p)              { return __hip_atomic_load(p, __ATOMIC_RELAXED, __HIP_MEMORY_SCOPE_AGENT); }
__device__ __forceinline__ unsigned xb_add(unsigned* p, unsigned v) { return __hip_atomic_fetch_add(p, v, __ATOMIC_RELAXED, __HIP_MEMORY_SCOPE_AGENT); }
__device__ __forceinline__ unsigned xb_xcc_id() { return (unsigned)__builtin_amdgcn_s_getreg((3 << 11) | 20) & 0xFu; }
#define XB_SPIN(cond, bar) do { unsigned _sp = 0; while (cond) { __builtin_amdgcn_s_sleep(1); \
    if ((++_sp & 255u) == 0u) { if (xb_ld(&(bar)[XB_TMO])) break; if (_sp > XB_SPIN_CAP) { atomicAdd(&(bar)[XB_TMO], 1u); break; } } } } while (0)

struct XcdBarrier { unsigned* bar; unsigned x; volatile LAS unsigned* st; };

__device__ __forceinline__ XcdBarrier xcd_barrier_post(unsigned* bar, volatile LAS unsigned* st) {
    XcdBarrier b; b.bar = bar; b.x = xb_xcc_id(); b.st = st;
    if (threadIdx.x == 0) (void)xb_add(&bar[XB_XCNT(b.x)], 1u);
    return b;
}
__device__ __forceinline__ void xcd_barrier_complete(unsigned* bar, unsigned x, unsigned& nloc, unsigned& nx) {
    const unsigned G = gridDim.x * gridDim.y * gridDim.z;
    unsigned sum, cnt, mine, sp = 0u;
    for (;;) {
        sum = 0u; cnt = 0u; mine = 0u;
#pragma unroll
        for (unsigned j = 0; j < 16; ++j) { const unsigned c = xb_ld(&bar[XB_XCNT(j)]); sum += c; cnt += (c > 0u) ? 1u : 0u; mine = (j == x) ? c : mine; }
        if (sum == G) break;
        __builtin_amdgcn_s_sleep(1);
        if ((++sp & 255u) == 0u) { if (xb_ld(&bar[XB_TMO])) break; if (sp > XB_SPIN_CAP) { atomicAdd(&bar[XB_TMO], 1u); break; } }
    }
    nloc = mine > 0u ? mine : 1u; nx = cnt > 0u ? cnt : 1u;
}
__device__ __forceinline__ void xcd_barrier(const XcdBarrier& b) {
    asm volatile("s_waitcnt vmcnt(0)" ::: "memory");
    __syncthreads();
    if (threadIdx.x == 0) {
        unsigned* bar = b.bar;
        __builtin_amdgcn_s_waitcnt(0);
        unsigned nloc = b.st[0], nx = b.st[1];
        if (nloc == 0u) { xcd_barrier_complete(bar, b.x, nloc, nx); b.st[0] = nloc; b.st[1] = nx; }
        const unsigned old = xb_add(&bar[XB_XSUB(b.x)], 1u);
        const unsigned gen = old / nloc;
        if (old + 1u == (gen + 1u) * nloc) {
            __builtin_amdgcn_fence(__ATOMIC_RELEASE, "agent");
            asm volatile("s_waitcnt vmcnt(0)" ::: "memory");
            const unsigned og = xb_add(&bar[XB_TOP], 1u);
            const unsigned tg = og / nx;
            if (og + 1u == (tg + 1u) * nx) xb_add(&bar[XB_TOPGEN], 1u);
            else XB_SPIN(xb_ld(&bar[XB_TOPGEN]) == tg, bar);
            __builtin_amdgcn_fence(__ATOMIC_ACQUIRE, "agent");
            xb_add(&bar[XB_XGEN(b.x)], 1u);
            asm volatile("s_waitcnt vmcnt(0)" ::: "memory");
        } else {
            XB_SPIN(xb_ld(&bar[XB_XGEN(b.x)]) == gen, bar);
            __builtin_amdgcn_fence(__ATOMIC_ACQUIRE, "agent");
            asm volatile("s_waitcnt vmcnt(0)" ::: "memory");
        }
    }
    __syncthreads();
}

struct Args { const float* in[22]; float* out; unsigned char* ws; int ph_lo, ph_hi; };
struct Frame {
    LAS unsigned char* lds;
    unsigned char* ws; unsigned char* dout;
    int tid, lane, wave, bid, G;
};

__device__ __forceinline__ void p0_transpose_item(const float* W, int ldw, int sc0, const float* gs, bf16* WT, int ldt, int dr0, int k0, LAS float* scr, int lane) {
#pragma unroll 8
    for (int i = 0; i < 32; ++i) { const int kk = 2 * i + (lane >> 5); float v = W[(size_t)(k0 + kk) * ldw + sc0 + (lane & 31)]; if (gs) v *= gs[k0 + kk]; scr[kk * 33 + (lane & 31)] = v; }
    LDS_WAIT(); asm volatile("" ::: "memory");
    const int c = lane & 7;
#pragma unroll
    for (int j = 0; j < 4; ++j) { const int n = (lane >> 3) + 8 * j; const LAS float* s = scr + (8 * c) * 33 + n;
        u32x4 o; o.x = pk2(s[0 * 33], s[1 * 33]); o.y = pk2(s[2 * 33], s[3 * 33]); o.z = pk2(s[4 * 33], s[5 * 33]); o.w = pk2(s[6 * 33], s[7 * 33]);
        *(u32x4*)(WT + (size_t)(dr0 + n) * ldt + k0 + 8 * c) = o; }
    LDS_WAIT(); asm volatile("" ::: "memory");
}

__device__ __forceinline__ void p0_prologue(const Frame& F, const Args& A) {
    LAS float* scr = (LAS float*)(F.lds + F.wave * 16384);
    const int gw = F.bid * 8 + F.wave, NGW = F.G * 8;
    const float* w_in = A.in[3];
    bf16* WIN = (bf16*)(F.ws + WS_WIN); bf16* WKV = (bf16*)(F.ws + WS_WKV); bf16* WBR = (bf16*)(F.ws + WS_WBR); bf16* WOUT = (bf16*)(F.ws + WS_WOUT); bf16* WQ = (bf16*)(F.ws + WS_WQ);
    constexpr int I_IN = 16 * 224, I_KV = 16 * 32, I_BR = 8 * 32, I_OUT = 16 * 32, I_Q = 16 * 64;
    constexpr int NITEMS = I_IN + I_KV + 3 * I_BR + I_OUT + I_Q;
    for (int it = gw; it < NITEMS; it += NGW) {
        int r = it;
        if (r < I_IN) { const int kb = r / 224, nb = r % 224, n0 = 32 * nb; p0_transpose_item(w_in, INC, n0 < 3584 ? n0 : n0 + 8, A.in[2], WIN, D, n0, 64 * kb, scr, F.lane); continue; } r -= I_IN;
        if (r < I_KV) { const int kb = r / 32, nb = r % 32; p0_transpose_item(A.in[12], D, 32 * nb, A.in[11], WKV, D, 32 * nb, 64 * kb, scr, F.lane); continue; } r -= I_KV;
        if (r < 3 * I_BR) { const int z = r / I_BR, q = r % I_BR, kb = q / 32, nb = q % 32; p0_transpose_item(A.in[15] + (size_t)z * 512 * D, D, 32 * nb, nullptr, WBR + (size_t)z * D * 512, 512, 32 * nb, 64 * kb, scr, F.lane); continue; } r -= 3 * I_BR;
        if (r < I_OUT) { const int kb = r / 32, nb = r % 32; p0_transpose_item(A.in[16], D, 32 * nb, nullptr, WOUT, D, 32 * nb, 64 * kb, scr, F.lane); continue; } r -= I_OUT;
        { const int kb = r / 64, nb = r % 64; p0_transpose_item(A.in[18], 2048, 32 * nb, A.in[17], WQ, D, 32 * nb, 64 * kb, scr, F.lane); }
    }
    { bf16* SK = (bf16*)(F.ws + WS_SK); const float* sk = A.in[19];
      for (int i = F.bid * 512 + F.tid; i < 2 * 128 * 128; i += F.G * 512) SK[i] = (bf16)f2bf(sk[i]); }
    __syncthreads();
    LAS float* slab = (LAS float*)F.lds;
    for (int e = F.tid; e < 8 * D; e += 512) { const int c = e & 7, k = e >> 3; slab[c * D + k] = w_in[(size_t)k * INC + 3584 + c] * A.in[2][k]; }
    __syncthreads();
    const float* x = A.in[0]; bf16* XN = (bf16*)(F.dout + DO_XN); float* BG = (float*)(F.ws + WS_BG);
    for (int m = gw; m < T; m += NGW) {
        const f32x4* xr = (const f32x4*)(x + (size_t)m * D) + F.lane;
        f32x4 v[4]; float s = 0.f;
#pragma unroll
        for (int j = 0; j < 4; ++j) { v[j] = xr[64 * j]; s += (v[j].x * v[j].x + v[j].y * v[j].y) + (v[j].z * v[j].z + v[j].w * v[j].w); }
        const float rstd = 1.f / sqrtf(wave_sum(s) * (1.f / D) + EPS);
        unsigned long long* o8 = (unsigned long long*)(XN + (size_t)m * D) + F.lane;
#pragma unroll
        for (int j = 0; j < 4; ++j) o8[64 * j] = (unsigned long long)pk2(v[j].x * rstd, v[j].y * rstd) | ((unsigned long long)pk2(v[j].z * rstd, v[j].w * rstd) << 32);
        float acc[8];
#pragma unroll
        for (int c = 0; c < 8; ++c) { float a = 0.f;
#pragma unroll
            for (int j = 0; j < 4; ++j) { const f32x4 w = *(const LAS f32x4*)(slab + c * D + 256 * j + 4 * F.lane); a += (v[j].x * w.x + v[j].y * w.y) + (v[j].z * w.z + v[j].w * w.w); }
            acc[c] = wave_sum(a) * rstd; }
        if (F.lane < 8) {
            float val = acc[0];
#pragma unroll
            for (int c = 1; c < 8; ++c) val = (F.lane == c) ? acc[c] : val;
            const int h = F.lane & 3; float o;
            if (F.lane < 4) o = sigmoidf_(val);
            else { const float z = val + A.in[9][h]; const float sp = fmaxf(z, 0.f) + log1pf(__expf(-fabsf(z))); o = -__expf(A.in[8][h]) * sp; }
            BG[(size_t)m * 8 + F.lane] = o;
        }
    }
    const float* mem = A.in[1]; bf16* MEMN = (bf16*)(F.ws + WS_MEMN);
    for (int m = gw; m < NB * MEMT; m += NGW) {
        const f32x4* xr = (const f32x4*)(mem + (size_t)m * D) + F.lane;
        f32x4 v[4]; float s = 0.f;
#pragma unroll
        for (int j = 0; j < 4; ++j) { v[j] = xr[64 * j]; s += (v[j].x * v[j].x + v[j].y * v[j].y) + (v[j].z * v[j].z + v[j].w * v[j].w); }
        const float rstd = 1.f / sqrtf(wave_sum(s) * (1.f / D) + EPS);
        unsigned long long* o8 = (unsigned long long*)(MEMN + (size_t)m * D) + F.lane;
#pragma unroll
        for (int j = 0; j < 4; ++j) o8[64 * j] = (unsigned long long)pk2(v[j].x * rstd, v[j].y * rstd) | ((unsigned long long)pk2(v[j].z * rstd, v[j].w * rstd) << 32);
    }
    __syncthreads();
}

struct SchedGrid {
    int nM, nN, G, c; const char* A; const char* B; size_t tA, tB;
    __device__ __forceinline__ bool next(int i, pg8::Unit& u) const {
        int pm, pn; if (!pg8::tile_of((long)i * G + c, nM, nN, pm, pn)) return false;
        u.pm = pm; u.pn = pn; u.z = 0; u.a = A + (size_t)pm * tA; u.b = B + (size_t)pn * tB; return true; }
};
struct SchedOne {
    bool have; int pm, pn; const char* a; const char* b;
    __device__ __forceinline__ bool next(int i, pg8::Unit& u) const { if (!have || i > 0) return false; u.pm = pm; u.pn = pn; u.z = 0; u.a = a; u.b = b; return true; }
};
struct SchedBranch {
    int G, c; const char* A0; long d1, d2; const char* B;
    __device__ __forceinline__ bool next(int i, pg8::Unit& u) const {
        const int z = i % 3; int pm, pn; if (!pg8::tile_of((long)(i / 3) * G + c, 64, 4, pm, pn)) return false;
        u.pm = pm; u.pn = pn; u.z = z;
        u.a = A0 + (long)(z & 1) * d1 + (long)(z >> 1) * d2 + (size_t)pm * 256 * 512 * 2; u.b = B + ((size_t)z * 1024 + (size_t)pn * 256) * 512 * 2; return true; }
};

#define EPI_LOOP_BEGIN \
    const int row0 = u.pm * 256 + wr * 64 + fr, col0 = u.pn * 256 + wc * 32 + 8 * fq; \
    _Pragma("unroll") for (int ai = 0; ai < 2; ++ai) _Pragma("unroll") for (int m = 0; m < 4; ++m) { const int row = row0 + ai * 128 + m * 16; \
        _Pragma("unroll") for (int bj = 0; bj < 2; ++bj) { const int col = col0 + bj * 128; f32x4 v0 = acc[ai][bj][m][0], v1 = acc[ai][bj][m][1];
#define EPI_LOOP_END } }
#define PACK8(v0, v1) ({ u32x4 w_; w_.x = pg8::cvt_pk_bf16(v0[0], v0[1]); w_.y = pg8::cvt_pk_bf16(v0[2], v0[3]); w_.z = pg8::cvt_pk_bf16(v1[0], v1[1]); w_.w = pg8::cvt_pk_bf16(v1[2], v1[3]); w_; })

struct EpiStore {
    bf16* O; int ldc; int sig;
    __device__ __forceinline__ void operator()(const f32x4 (&acc)[2][2][4][2], const pg8::Unit& u, int wr, int wc, int fr, int fq) const {
        EPI_LOOP_BEGIN
            if (sig) {
#pragma unroll
                for (int e = 0; e < 4; ++e) { v0[e] = sigmoidf_(v0[e]); v1[e] = sigmoidf_(v1[e]); } }
            *(u32x4*)(O + (size_t)row * ldc + col) = PACK8(v0, v1);
        EPI_LOOP_END
    }
};
struct EpiBranch {
    const bf16* gates; bf16* merged;
    __device__ __forceinline__ void operator()(const f32x4 (&acc)[2][2][4][2], const pg8::Unit& u, int wr, int wc, int fr, int fq) const {
        EPI_LOOP_BEGIN
            const u32x4 gw = *(const u32x4*)(gates + (size_t)row * NG + u.z * 1024 + col); float g[8]; unpack8(gw, g);
            bf16* mp = merged + (size_t)row * D + col;
#pragma unroll
            for (int e = 0; e < 4; ++e) { v0[e] *= g[e]; v1[e] *= g[4 + e]; }
            if (u.z > 0) { const u32x4 ow = *(const u32x4*)mp; float o[8]; unpack8(ow, o);
#pragma unroll
                for (int e = 0; e < 4; ++e) { v0[e] += o[e]; v1[e] += o[4 + e]; } }
            *(u32x4*)mp = PACK8(v0, v1);
        EPI_LOOP_END
    }
};
struct EpiOut {
    const float* x; float* out; bf16* hb; float* rowss;
    __device__ __forceinline__ void operator()(const f32x4 (&acc)[2][2][4][2], const pg8::Unit& u, int wr, int wc, int fr, int fq) const {
        const int row0 = u.pm * 256 + wr * 64 + fr, col0 = u.pn * 256 + wc * 32 + 8 * fq;
#pragma unroll
        for (int ai = 0; ai < 2; ++ai)
#pragma unroll
            for (int m = 0; m < 4; ++m) { const int row = row0 + ai * 128 + m * 16; float ss = 0.f;
#pragma unroll
                for (int bj = 0; bj < 2; ++bj) { const int col = col0 + bj * 128; const size_t off = (size_t)row * D + col;
                    const f32x4 x0 = *(const f32x4*)(x + off), x1 = *(const f32x4*)(x + off + 4);
                    const f32x4 v0 = acc[ai][bj][m][0] + x0, v1 = acc[ai][bj][m][1] + x1;
                    *(f32x4*)(out + off) = v0; *(f32x4*)(out + off + 4) = v1;
                    *(u32x4*)(hb + off) = PACK8(v0, v1);
                    ss += (v0[0] * v0[0] + v0[1] * v0[1]) + (v0[2] * v0[2] + v0[3] * v0[3]) + (v1[0] * v1[0] + v1[1] * v1[1]) + (v1[2] * v1[2] + v1[3] * v1[3]); }
                ss += __shfl_xor(ss, 16); ss += __shfl_xor(ss, 32);
                if (fq == 0) atomicAdd(rowss + row, ss); }
    }
};
struct EpiQry {
    const float* rowss; bf16* O;
    __device__ __forceinline__ void operator()(const f32x4 (&acc)[2][2][4][2], const pg8::Unit& u, int wr, int wc, int fr, int fq) const {
        const int row0 = u.pm * 256 + wr * 64 + fr, col0 = u.pn * 256 + wc * 32 + 8 * fq;
#pragma unroll
        for (int ai = 0; ai < 2; ++ai)
#pragma unroll
            for (int m = 0; m < 4; ++m) { const int row = row0 + ai * 128 + m * 16;
                const float rstd = 1.f / sqrtf(__hip_atomic_load(rowss + row, RLX_AGENT) * (1.f / D) + EPS);
#pragma unroll
                for (int bj = 0; bj < 2; ++bj) { const int col = col0 + bj * 128; const f32x4 v0 = acc[ai][bj][m][0] * rstd, v1 = acc[ai][bj][m][1] * rstd;
                    *(u32x4*)(O + (size_t)row * 2048 + col) = PACK8(v0, v1); } }
    }
};

constexpr int AT_KS = 0, AT_VT = 33792, AT_PS = 70656, AT_BIAS = 107520;

template <int HD>
__device__ __forceinline__ void at_stage_norm(LAS unsigned char* Ks, const bf16* src, int ld, const float* gain, float scale, int tid) {
#pragma unroll
    for (int it = 0; it < 4; ++it) {
        const int id = it * 512 + tid, row = id >> 5, ch = id & 31;
        const u32x4 raw = *(const u32x4*)(src + (size_t)row * ld + ch * 8);
        float v[8]; unpack8(raw, v);
        float ss = 0.f;
#pragma unroll
        for (int j = 0; j < 8; ++j) ss += v[j] * v[j];
        ss += __shfl_xor(ss, 1); ss += __shfl_xor(ss, 2); ss += __shfl_xor(ss, 4);
        if (HD == 128) ss += __shfl_xor(ss, 8);
        const float rs = scale / sqrtf(ss * (1.f / HD) + EPS);
        const int g0 = (ch * 8) & (HD - 1);
        const f32x4 ga = *(const f32x4*)(gain + g0), gb = *(const f32x4*)(gain + g0 + 4);
        v[0] *= rs * ga[0]; v[1] *= rs * ga[1]; v[2] *= rs * ga[2]; v[3] *= rs * ga[3];
        v[4] *= rs * gb[0]; v[5] *= rs * gb[1]; v[6] *= rs * gb[2]; v[7] *= rs * gb[3];
        *(LAS u32x4*)(Ks + row * 528 + ch * 16) = pack8(v);
    }
}
__device__ __forceinline__ void at_stage_vt(LAS unsigned char* Vt, const bf16* src, int ld, int tid) {
#pragma unroll
    for (int it = 0; it < 4; ++it) {
        const int id = it * 512 + tid, key = id & 63, ch = id >> 6;
        const u32x4 raw = *(const u32x4*)(src + (size_t)key * ld + ch * 8);
        LAS bf16* p = (LAS bf16*)(Vt + (ch * 8) * 144 + key * 2);
        p[0 * 72] = (bf16)(raw.x & 0xffffu); p[1 * 72] = (bf16)(raw.x >> 16); p[2 * 72] = (bf16)(raw.y & 0xffffu); p[3 * 72] = (bf16)(raw.y >> 16);
        p[4 * 72] = (bf16)(raw.z & 0xffffu); p[5 * 72] = (bf16)(raw.z >> 16); p[6 * 72] = (bf16)(raw.w & 0xffffu); p[7 * 72] = (bf16)(raw.w >> 16);
    }
}

template <int HD, bool BIAS>
__device__ __forceinline__ void attn_item(const Frame& F, const bf16* Qsrc, int ldq, const float* qgain, float qscale,
                                          const bf16* Ktile0, const bf16* Vtile0, int ldkv, long tstride, int j0, int j1, const float* kgain,
                                          const float* biasg, bf16* Out, int ldo) {
    constexpr int NH = 256 / HD, WPH = 8 / NH, QW = 64 / WPH, QT = QW / 16, KSN = HD / 32, DT = HD / 16;
    LAS unsigned char* Ks = F.lds + AT_KS; LAS unsigned char* Vt = F.lds + AT_VT; LAS unsigned char* Psw = F.lds + AT_PS + F.wave * 4608;
    LAS float* bias = (LAS float*)(F.lds + AT_BIAS);
    const int lane = F.lane, fr = lane & 15, fg = lane >> 4;
    const int hw = F.wave / WPH, qbase = (F.wave % WPH) * QW;
    __syncthreads();
    at_stage_norm<HD>(Ks, Qsrc, ldq, qgain, qscale, F.tid);
    if (BIAS) { for (int i = F.tid; i < NH * 257; i += 512) bias[i] = biasg[i]; }
    __syncthreads();
    bf16x8 qf[QT][KSN];
#pragma unroll
    for (int qt = 0; qt < QT; ++qt)
#pragma unroll
        for (int s = 0; s < KSN; ++s) qf[qt][s] = *(const LAS bf16x8*)(Ks + (qbase + 16 * qt + fr) * 528 + (hw * HD + 32 * s + 8 * fg) * 2);
    f32x4 O[QT][DT]; float mrow[QT][4], lrow[QT][4];
#pragma unroll
    for (int qt = 0; qt < QT; ++qt) {
#pragma unroll
        for (int dt = 0; dt < DT; ++dt) O[qt][dt] = (f32x4){0.f, 0.f, 0.f, 0.f};
#pragma unroll
        for (int r = 0; r < 4; ++r) { mrow[qt][r] = -1e30f; lrow[qt][r] = 0.f; } }
    for (int j = j0; j < j1; ++j) {
        __syncthreads();
        at_stage_norm<HD>(Ks, Ktile0 + (long)j * tstride, ldkv, kgain, 1.f, F.tid);
        at_stage_vt(Vt, Vtile0 + (long)j * tstride, ldkv, F.tid);
        __syncthreads();
        f32x4 S[QT][4];
#pragma unroll
        for (int kt = 0; kt < 4; ++kt) {
            bf16x8 kb[KSN];
#pragma unroll
            for (int s = 0; s < KSN; ++s) kb[s] = *(const LAS bf16x8*)(Ks + (16 * kt + fr) * 528 + (hw * HD + 32 * s + 8 * fg) * 2);
#pragma unroll
            for (int qt = 0; qt < QT; ++qt) { f32x4 a = (f32x4){0.f, 0.f, 0.f, 0.f};
#pragma unroll
                for (int s = 0; s < KSN; ++s) a = MFMA16(qf[qt][s], kb[s], a);
                S[qt][kt] = a; }
        }
        if (BIAS) {
            if (j <= 5) { const float bc = bias[hw * 257 + 256];
#pragma unroll
                for (int qt = 0; qt < QT; ++qt)
#pragma unroll
                    for (int kt = 0; kt < 4; ++kt) S[qt][kt] += bc;
            } else {
#pragma unroll
                for (int qt = 0; qt < QT; ++qt)
#pragma unroll
                    for (int kt = 0; kt < 4; ++kt)
#pragma unroll
                        for (int r = 0; r < 4; ++r) { int rel = (qbase + 16 * qt + 4 * fg + r) - (16 * kt + fr) + 64 * (8 - j); rel = rel > 128 ? 128 : (rel < -128 ? -128 : rel);
                            S[qt][kt][r] += bias[hw * 257 + rel + 128]; }
            }
        }
#pragma unroll
        for (int qt = 0; qt < QT; ++qt) {
#pragma unroll
            for (int r = 0; r < 4; ++r) {
                float mx = fmaxf(fmaxf(S[qt][0][r], S[qt][1][r]), fmaxf(S[qt][2][r], S[qt][3][r]));
                mx = fmaxf(mx, __shfl_xor(mx, 1)); mx = fmaxf(mx, __shfl_xor(mx, 2)); mx = fmaxf(mx, __shfl_xor(mx, 4)); mx = fmaxf(mx, __shfl_xor(mx, 8));
                const float mnew = fmaxf(mrow[qt][r], mx), alpha = __expf(mrow[qt][r] - mnew); mrow[qt][r] = mnew;
                float rs = 0.f;
#pragma unroll
                for (int kt = 0; kt < 4; ++kt) { const float p = __expf(S[qt][kt][r] - mnew); S[qt][kt][r] = p; rs += p; }
                rs += __shfl_xor(rs, 1); rs += __shfl_xor(rs, 2); rs += __shfl_xor(rs, 4); rs += __shfl_xor(rs, 8);
                lrow[qt][r] = lrow[qt][r] * alpha + rs;
#pragma unroll
                for (int dt = 0; dt < DT; ++dt) O[qt][dt][r] *= alpha;
            }
#pragma unroll
            for (int kt = 0; kt < 4; ++kt)
#pragma unroll
                for (int r = 0; r < 4; ++r) *(LAS bf16*)(Psw + (16 * qt + 4 * fg + r) * 144 + (16 * kt + fr) * 2) = (bf16)f2bf(S[qt][kt][r]);
        }
        LDS_WAIT();
#pragma unroll
        for (int s = 0; s < 2; ++s) {
            bf16x8 pa[QT];
#pragma unroll
            for (int qt = 0; qt < QT; ++qt) pa[qt] = *(const LAS bf16x8*)(Psw + (16 * qt + fr) * 144 + (32 * s + 8 * fg) * 2);
#pragma unroll
            for (int dt = 0; dt < DT; ++dt) { const bf16x8 vb = *(const LAS bf16x8*)(Vt + (hw * HD + 16 * dt + fr) * 144 + (32 * s + 8 * fg) * 2);
#pragma unroll
                for (int qt = 0; qt < QT; ++qt) O[qt][dt] = MFMA16(pa[qt], vb, O[qt][dt]); }
        }
        LDS_WAIT();
    }
#pragma unroll
    for (int qt = 0; qt < QT; ++qt)
#pragma unroll
        for (int r = 0; r < 4; ++r) { const float inv = 1.f / lrow[qt][r]; bf16* op = Out + (size_t)(qbase + 16 * qt + 4 * fg + r) * ldo + hw * HD + fr;
#pragma unroll
            for (int dt = 0; dt < DT; ++dt) op[16 * dt] = (bf16)f2bf(O[qt][dt][r] * inv); }
}

__device__ __forceinline__ void attn_dispatch(const Frame& F, const Args& A, int item) {
    const bf16* PROJ = (const bf16*)(F.ws + WS_PROJ);
    if (item < 512) {
        const int hg = item & 1, cc = (item >> 1) & 63, b = item >> 7; const size_t t0 = (size_t)b * SEQ + (size_t)cc * CH;
        const bf16* q = PROJ + t0 * NPA + hg * 256; const bf16* kown = PROJ + t0 * NPA + 512 + hg * 256; const bf16* vown = PROJ + t0 * NPA + 1024 + hg * 256;
        const long ts = (long)CH * NPA;
        attn_item<64, true>(F, q, NPA, A.in[4], 0.125f, kown - 8 * ts, vown - 8 * ts, NPA, ts, cc >= 8 ? 0 : 8 - cc, 9, A.in[5],
                            A.in[6] + (size_t)hg * 4 * 257, (bf16*)(F.dout + DO_OA) + t0 * 512 + hg * 256, 512);
    } else {
        const int m = item - 512, hp = m & 1, tile = m >> 1; const size_t t0 = (size_t)tile * 64; const int b = (int)(t0 / SEQ);
        const bf16* KVM = (const bf16*)(F.ws + WS_KVM);
        const bf16* q = PROJ + t0 * NPA + 3584 + hp * 256; const bf16* k0 = KVM + (size_t)b * MEMT * D + hp * 256; const bf16* v0 = k0 + 512;
        attn_item<128, false>(F, q, NPA, A.in[13], 0.08838834764831845f, k0, v0, D, (long)64 * D, 0, 4, A.in[14], nullptr, (bf16*)(F.dout + DO_OM) + t0 * 512 + hp * 256, 512);
    }
}

constexpr int GP_KN = 0, GP_QN = 17408, GP_VN = 34816, GP_A = 52224, GP_GC = 68608, GP_BETA = 68864, GP_KDT = 69632;

__device__ __forceinline__ void gdn_prep_item(const Frame& F, const Args& A, int item) {
    const int cc = item & 63, h = (item >> 6) & 3, b = item >> 8;
    const size_t t0 = (size_t)b * SEQ + (size_t)cc * CH;
    const bf16* PROJ = (const bf16*)(F.ws + WS_PROJ);
    const float* BG = (const float*)(F.ws + WS_BG);
    const float* convw = A.in[7];
    LAS unsigned char* L = F.lds;
    LAS float* Amat = (LAS float*)(L + GP_A); LAS float* gcv = (LAS float*)(L + GP_GC); LAS float* betav = (LAS float*)(L + GP_BETA);
    const int tid = F.tid, lane = F.lane, fr = lane & 15, fg = lane >> 4;
    __syncthreads();
#pragma unroll
    for (int part = 0; part < 3; ++part) {
#pragma unroll
        for (int it = 0; it < 2; ++it) {
            const int id = it * 512 + tid, row = id >> 4, ch = id & 15;
            const int col = 1536 + part * 512 + h * 128 + ch * 8;
            float y[8];
#pragma unroll
            for (int j = 0; j < 8; ++j) y[j] = 0.f;
#pragma unroll
            for (int tau = 0; tau < 4; ++tau) {
                const int sl = cc * CH + row - 3 + tau;
                if (sl >= 0) {
                    const u32x4 raw = *(const u32x4*)(PROJ + ((size_t)b * SEQ + sl) * NPA + col); float v[8]; unpack8(raw, v);
                    const f32x4 w0 = *(const f32x4*)(convw + tau * 1536 + (col - 1536)), w1 = *(const f32x4*)(convw + tau * 1536 + (col - 1536) + 4);
                    y[0] += v[0] * w0[0]; y[1] += v[1] * w0[1]; y[2] += v[2] * w0[2]; y[3] += v[3] * w0[3];
                    y[4] += v[4] * w1[0]; y[5] += v[5] * w1[1]; y[6] += v[6] * w1[2]; y[7] += v[7] * w1[3];
                }
            }
            float ss = 0.f;
#pragma unroll
            for (int j = 0; j < 8; ++j) { y[j] = siluf_(y[j]); ss += y[j] * y[j]; }
            if (part < 2) {
                ss += __shfl_xor(ss, 1); ss += __shfl_xor(ss, 2); ss += __shfl_xor(ss, 4); ss += __shfl_xor(ss, 8);
                const float rs = (part == 0 ? 0.08838834764831845f : 1.f) / sqrtf(ss + EPS);
#pragma unroll
                for (int j = 0; j < 8; ++j) y[j] *= rs;
            }
            *(LAS u32x4*)(L + (part == 0 ? GP_QN : (part == 1 ? GP_KN : GP_VN)) + row * 272 + ch * 16) = pack8(y);
        }
    }
    if (F.wave == 0) {
        float g = BG[(t0 + lane) * 8 + 4 + h];
#pragma unroll
        for (int o = 1; o < 64; o <<= 1) { const float n = __shfl_up(g, o); if (lane >= o) g += n; }
        gcv[lane] = g; betav[lane] = BG[(t0 + lane) * 8 + h];
    }
    __syncthreads();
    const float gclast = gcv[63];
    bf16* QKg = (bf16*)(F.ws + WS_PQK) + (size_t)item * 4096;
#pragma unroll
    for (int tt = 0; tt < 2; ++tt) {
        const int tile = F.wave + 8 * tt, mt = tile >> 2, nt = tile & 3;
        f32x4 akk = (f32x4){0.f, 0.f, 0.f, 0.f}, aqk = (f32x4){0.f, 0.f, 0.f, 0.f};
        if (nt <= mt) {
#pragma unroll
            for (int s = 0; s < 4; ++s) {
                const bf16x8 kj = *(const LAS bf16x8*)(L + GP_KN + (16 * nt + fr) * 272 + (32 * s + 8 * fg) * 2);
                const bf16x8 ki = *(const LAS bf16x8*)(L + GP_KN + (16 * mt + fr) * 272 + (32 * s + 8 * fg) * 2);
                const bf16x8 qi = *(const LAS bf16x8*)(L + GP_QN + (16 * mt + fr) * 272 + (32 * s + 8 * fg) * 2);
                akk = MFMA16(ki, kj, akk); aqk = MFMA16(qi, kj, aqk);
            }
        }
        const int jj = 16 * nt + fr; const float gj = gcv[jj];
#pragma unroll
        for (int r = 0; r < 4; ++r) { const int ii = 16 * mt + 4 * fg + r; const float e = __expf(gcv[ii] - gj);
            Amat[ii * 64 + jj] = (ii > jj) ? betav[ii] * akk[r] * e : 0.f;
            QKg[ii * 64 + jj] = (bf16)f2bf((ii >= jj) ? aqk[r] * e : 0.f); }
    }
    __syncthreads();
    if (F.wave < 4) {
        float xv[64];
        const int colr = tid;
        if (colr < 128) {
#pragma unroll
            for (int i = 0; i < 64; ++i) xv[i] = bf2f(*(const LAS bf16*)(L + GP_VN + i * 272 + colr * 2)) * betav[i];
        } else {
#pragma unroll
            for (int i = 0; i < 64; ++i) xv[i] = bf2f(*(const LAS bf16*)(L + GP_KN + i * 272 + (colr - 128) * 2)) * betav[i] * __expf(gcv[i]);
        }
#pragma unroll
        for (int i = 1; i < 64; ++i) { float a = xv[i];
#pragma unroll
            for (int j = 0; j < i; ++j) a -= Amat[i * 64 + j] * xv[j];
            xv[i] = a; }
        bf16* dst = (colr < 128) ? ((bf16*)(F.ws + WS_PU) + (size_t)item * 8192 + colr) : ((bf16*)(F.ws + WS_PW) + (size_t)item * 8192 + (colr - 128));
#pragma unroll
        for (int i = 0; i < 64; ++i) dst[i * 128] = (bf16)f2bf(xv[i]);
    } else {
        const int t2 = tid - 256;
        bf16* QD = (bf16*)(F.ws + WS_PQD) + (size_t)item * 8192;
#pragma unroll
        for (int it = 0; it < 4; ++it) {
            const int id = it * 256 + t2;
            { const int row = id >> 4, ch = id & 15; const u32x4 raw = *(const LAS u32x4*)(L + GP_QN + row * 272 + ch * 16); float v[8]; unpack8(raw, v); const float e = __expf(gcv[row]);
#pragma unroll
              for (int j = 0; j < 8; ++j) v[j] *= e;
              *(u32x4*)(QD + row * 128 + ch * 8) = pack8(v); }
            { const int i = id & 63, ch = id >> 6; const u32x4 raw = *(const LAS u32x4*)(L + GP_KN + i * 272 + ch * 16); float v[8]; unpack8(raw, v); const float e = __expf(gclast - gcv[i]);
              LAS bf16* p = (LAS bf16*)(L + GP_KDT + (ch * 8) * 144 + i * 2);
#pragma unroll
              for (int j = 0; j < 8; ++j) p[j * 72] = (bf16)f2bf(v[j] * e); }
        }
    }
    __syncthreads();
    { bf16* KDT = (bf16*)(F.ws + WS_PKDT) + (size_t)item * 8192;
#pragma unroll
      for (int it = 0; it < 2; ++it) { const int id = it * 512 + tid, d = id >> 3, c8 = id & 7;
          *(u32x4*)(KDT + d * 64 + c8 * 8) = *(const LAS u32x4*)(L + GP_KDT + d * 144 + c8 * 16); }
      if (tid == 0) ((float*)(F.ws + WS_GL))[item] = __expf(gclast); }
}

constexpr int SC_ST = 0, SC_VT = 8704;
struct ScanRegs { bf16x8 a4[4]; bf16x8 kd[2]; bf16x8 qk[2]; float u[4]; float gl; };

__device__ __forceinline__ void scan_load(ScanRegs& R, const unsigned char* ws, int bh, int c, int w, int fr, int fg, int dv0) {
    const size_t item = (size_t)bh * 64 + c;
    const bf16* src = (const bf16*)(ws + (w < 4 ? WS_PW : WS_PQD)) + item * 8192 + (size_t)(16 * (w & 3) + fr) * 128 + 8 * fg;
#pragma unroll
    for (int s = 0; s < 4; ++s) R.a4[s] = *(const bf16x8*)(src + 32 * s);
    const bf16* kd = (const bf16*)(ws + WS_PKDT) + item * 8192 + (size_t)(16 * w + fr) * 64 + 8 * fg;
    R.kd[0] = *(const bf16x8*)kd; R.kd[1] = *(const bf16x8*)(kd + 32);
    if (w >= 4) { const bf16* qk = (const bf16*)(ws + WS_PQK) + item * 4096 + (size_t)(16 * (w - 4) + fr) * 64 + 8 * fg; R.qk[0] = *(const bf16x8*)qk; R.qk[1] = *(const bf16x8*)(qk + 32); }
    else { const bf16* u = (const bf16*)(ws + WS_PU) + item * 8192 + (size_t)(16 * w + 4 * fg) * 128 + dv0 + fr;
#pragma unroll
        for (int r = 0; r < 4; ++r) R.u[r] = bf2f(u[r * 128]); }
    R.gl = ((const float*)(ws + WS_GL))[item];
}

__device__ __forceinline__ void gdn_scan_item(const Frame& F, int item) {
    const int bh = item >> 3, dv0 = (item & 7) * 16, b = bh >> 2, h = bh & 3;
    const int w = F.wave, lane = F.lane, fr = lane & 15, fg = lane >> 4;
    LAS unsigned char* L = F.lds;
    __syncthreads();
    for (int i = F.tid; i < (SC_VT + 2304) / 4; i += 512) ((LAS unsigned*)L)[i] = 0u;
    __syncthreads();
    f32x4 Sreg = (f32x4){0.f, 0.f, 0.f, 0.f};
    bf16* ORAW = (bf16*)(F.ws + WS_OB1);
    ScanRegs cur, nxt;
    scan_load(cur, F.ws, bh, 0, w, fr, fg, dv0);
    for (int c = 0; c < 64; ++c) {
        scan_load(nxt, F.ws, bh, c + 1 < 64 ? c + 1 : c, w, fr, fg, dv0);
        LAS unsigned char* STc = L + SC_ST + (c & 1) * 4352; LAS unsigned char* STn = L + SC_ST + ((c + 1) & 1) * 4352; LAS unsigned char* VT = L + SC_VT;
        f32x4 acc = (f32x4){0.f, 0.f, 0.f, 0.f};
#pragma unroll
        for (int s = 0; s < 4; ++s) { const bf16x8 sb = *(const LAS bf16x8*)(STc + fr * 272 + (32 * s + 8 * fg) * 2); acc = MFMA16(cur.a4[s], sb, acc); }
        if (w < 4) { u32x2 pk; pk.x = pk2(cur.u[0] - acc[0], cur.u[1] - acc[1]); pk.y = pk2(cur.u[2] - acc[2], cur.u[3] - acc[3]);
            *(LAS u32x2*)(VT + fr * 144 + (16 * w + 4 * fg) * 2) = pk; }
        __syncthreads();
        f32x4 sacc = Sreg * cur.gl;
        const bf16x8 v0 = *(const LAS bf16x8*)(VT + fr * 144 + (8 * fg) * 2), v1 = *(const LAS bf16x8*)(VT + fr * 144 + (32 + 8 * fg) * 2);
        sacc = MFMA16(cur.kd[0], v0, sacc); sacc = MFMA16(cur.kd[1], v1, sacc);
        Sreg = sacc;
        { u32x2 pk; pk.x = pk2(sacc[0], sacc[1]); pk.y = pk2(sacc[2], sacc[3]); *(LAS u32x2*)(STn + fr * 272 + (16 * w + 4 * fg) * 2) = pk; }
        if (w >= 4) { acc = MFMA16(cur.qk[0], v0, acc); acc = MFMA16(cur.qk[1], v1, acc);
            bf16* op = ORAW + ((size_t)b * SEQ + (size_t)c * CH + 16 * (w - 4) + 4 * fg) * 512 + h * 128 + dv0 + fr;
#pragma unroll
            for (int r = 0; r < 4; ++r) op[r * 512] = (bf16)f2bf(acc[r]); }
        __syncthreads();
        cur = nxt;
    }
}

__device__ __forceinline__ void p3b_phase(const Frame& F, const Args& A) {
    const int gt = F.bid * 512 + F.tid, NT = F.G * 512;
    bf16* OB = (bf16*)(F.ws + WS_OB1); const bf16* PROJ = (const bf16*)(F.ws + WS_PROJ); const float* gout = A.in[10];
    for (int id = gt; id < T * 64; id += NT) {
        const int row = id >> 6, ch = id & 63;
        const u32x4 raw = *(const u32x4*)(OB + (size_t)row * 512 + ch * 8); float v[8]; unpack8(raw, v);
        float ss = 0.f;
#pragma unroll
        for (int j = 0; j < 8; ++j) ss += v[j] * v[j];
        ss += __shfl_xor(ss, 1); ss += __shfl_xor(ss, 2); ss += __shfl_xor(ss, 4); ss += __shfl_xor(ss, 8);
        const float rs = 1.f / sqrtf(ss * (1.f / 128.f) + EPS);
        const u32x4 zr = *(const u32x4*)(PROJ + (size_t)row * NPA + 3072 + ch * 8); float z[8]; unpack8(zr, z);
        const int g0 = (ch * 8) & 127;
#pragma unroll
        for (int j = 0; j < 8; ++j) v[j] = v[j] * rs * gout[g0 + j] * siluf_(z[j]);
        *(u32x4*)(OB + (size_t)row * 512 + ch * 8) = pack8(v);
    }
    const float* pu = A.in[20]; const float* pv = A.in[21]; const float* gf = A.in[17];
    bf16* TU = (bf16*)(F.ws + WS_TU); bf16* TV = (bf16*)(F.ws + WS_TV);
    for (int id = gt; id < NEXP * 128; id += NT) {
        const size_t e = (size_t)id * 8; const int d0 = (int)(e & 1023);
        const f32x4 a0 = *(const f32x4*)(pu + e), a1 = *(const f32x4*)(pu + e + 4), g0 = *(const f32x4*)(gf + d0), g1 = *(const f32x4*)(gf + d0 + 4);
        u32x4 w; w.x = pk2(a0[0] * g0[0], a0[1] * g0[1]); w.y = pk2(a0[2] * g0[2], a0[3] * g0[3]); w.z = pk2(a1[0] * g1[0], a1[1] * g1[1]); w.w = pk2(a1[2] * g1[2], a1[3] * g1[3]);
        *(u32x4*)(TU + e) = w;
        const f32x4 b0 = *(const f32x4*)(pv + e), b1 = *(const f32x4*)(pv + e + 4);
        u32x4 x; x.x = pk2(b0[0], b0[1]); x.y = pk2(b0[2], b0[3]); x.z = pk2(b1[0], b1[1]); x.w = pk2(b1[2], b1[3]);
        *(u32x4*)(TV + e) = x;
    }
}

constexpr int PR_KEYS = 0, PR_TAB = 69632;
#define NEG_INF_F (-__builtin_inff())
__device__ __forceinline__ void ins16(float (&top)[16], float x) {
#pragma unroll
    for (int j = 0; j < 16; ++j) { const float hi = fmaxf(top[j], x); x = fminf(top[j], x); top[j] = hi; }
}
__device__ __forceinline__ void merge16(float (&a)[16], int mask) {
    float c[16];
#pragma unroll
    for (int i = 0; i < 16; ++i) c[i] = fmaxf(a[i], __shfl_xor(a[15 - i], mask));
#pragma unroll
    for (int st = 8; st >= 1; st >>= 1)
#pragma unroll
        for (int i = 0; i < 16; ++i) if ((i & st) == 0) { const float hi = fmaxf(c[i], c[i + st]), lo = fminf(c[i], c[i + st]); c[i] = hi; c[i + st] = lo; }
#pragma unroll
    for (int i = 0; i < 16; ++i) a[i] = c[i];
}
__device__ __forceinline__ float packlow(float v, unsigned code, unsigned mask) { return __builtin_bit_cast(float, (__builtin_bit_cast(unsigned, v) & ~mask) | code); }

__device__ __forceinline__ void peer_route_task(const Frame& F, int task) {
    const int lane = F.lane, fr = lane & 15, fg = lane >> 4;
    LAS unsigned char* L = F.lds;
    const bf16* QRY = (const bf16*)(F.ws + WS_QRY);
    const size_t R = (size_t)task * 16 + fr;
    float s1[16], s2[16];
#pragma unroll
    for (int p = 0; p < 2; ++p) {
        bf16x8 bq[4];
#pragma unroll
        for (int s = 0; s < 4; ++s) bq[s] = *(const bf16x8*)(QRY + R * 256 + p * 128 + 32 * s + 8 * fg);
        float top[16];
#pragma unroll
        for (int j = 0; j < 16; ++j) top[j] = NEG_INF_F;
#pragma unroll
        for (int nt = 0; nt < 8; ++nt) {
            f32x4 acc = (f32x4){0.f, 0.f, 0.f, 0.f};
#pragma unroll
            for (int s = 0; s < 4; ++s) { const bf16x8 ka = *(const LAS bf16x8*)(L + PR_KEYS + (p * 128 + 16 * nt + fr) * 272 + (32 * s + 8 * fg) * 2); acc = MFMA16(ka, bq[s], acc); }
#pragma unroll
            for (int r = 0; r < 4; ++r) ins16(top, packlow(acc[r], (unsigned)(16 * nt + 4 * fg + r), 0x7Fu));
        }
        merge16(top, 16); merge16(top, 32);
#pragma unroll
        for (int j = 0; j < 16; ++j) { if (p == 0) s1[j] = top[j]; else s2[j] = top[j]; }
    }
    LAS unsigned* tab = (LAS unsigned*)(L + PR_TAB + F.wave * 2048) + fr * 32;
#pragma unroll
    for (int j = 0; j < 16; ++j) { tab[j] = __builtin_bit_cast(unsigned, s1[j]) & 0x7Fu; tab[16 + j] = __builtin_bit_cast(unsigned, s2[j]) & 0x7Fu; }
    float fin[16];
#pragma unroll
    for (int j = 0; j < 16; ++j) fin[j] = packlow(s1[0] + s2[j], (unsigned)j, 0xFFu);
#pragma unroll
    for (int i = 1; i < 16; ++i)
#pragma unroll
        for (int j = 0; j < 16 / (i + 1); ++j) ins16(fin, packlow(s1[i] + s2[j], (unsigned)((i << 4) | j), 0xFFu));
    float es[16], sum = 0.f;
#pragma unroll
    for (int k = 0; k < 16; ++k) { es[k] = __expf(fin[k] - fin[0]); sum += es[k]; }
    const float inv = 1.f / sum;
    LDS_WAIT();
    int* EIDX = (int*)(F.ws + WS_EIDX); float* GW = (float*)(F.ws + WS_GW);
#pragma unroll
    for (int k = 0; k < 16; ++k) {
        const unsigned code = __builtin_bit_cast(unsigned, fin[k]) & 0xFFu;
        const unsigned i1 = tab[code >> 4], i2 = tab[16 + (code & 15u)];
        if (fg == (k >> 2)) { EIDX[R * 16 + k] = (int)(i1 * 128u + i2); GW[R * 16 + k] = es[k] * inv; }
    }
    LDS_WAIT();
}

__device__ __forceinline__ void peer_route_phase(const Frame& F) {
    __syncthreads();
    { const bf16* SK = (const bf16*)(F.ws + WS_SK);
      for (int id = F.tid; id < 256 * 16; id += 512) { const int row = id >> 4, ch = id & 15; *(LAS u32x4*)(F.lds + PR_KEYS + row * 272 + ch * 16) = *(const u32x4*)(SK + row * 128 + ch * 8); } }
    __syncthreads();
    const int gw = F.bid * 8 + F.wave, NGW = F.G * 8;
    for (int task = gw; task < T * 8 / 16; task += NGW) peer_route_task(F, task);
}

__device__ __forceinline__ void peer_gather_phase(const Frame& F, float* out) {
    const int gw = F.bid * 8 + F.wave, NGW = F.G * 8, lane = F.lane;
    const bf16* HB = (const bf16*)(F.ws + WS_HB); const bf16* TU = (const bf16*)(F.ws + WS_TU); const bf16* TV = (const bf16*)(F.ws + WS_TV);
    const int* EIDX = (const int*)(F.ws + WS_EIDX); const float* GW = (const float*)(F.ws + WS_GW);
    const float* rowss = (const float*)(F.ws + WS_CTL) + CW_ROWSS;
    for (int t = gw; t < T; t += NGW) {
        float xh[16];
        { const u32x4 h0 = *(const u32x4*)(HB + (size_t)t * D + 8 * lane), h1 = *(const u32x4*)(HB + (size_t)t * D + 512 + 8 * lane);
          float a[8], b[8]; unpack8(h0, a); unpack8(h1, b);
#pragma unroll
          for (int j = 0; j < 8; ++j) { xh[j] = a[j]; xh[8 + j] = b[j]; } }
        const float rstd = 1.f / sqrtf(__hip_atomic_load(rowss + t, RLX_AGENT) * (1.f / D) + EPS);
        float y[16];
#pragma unroll
        for (int j = 0; j < 16; ++j) y[j] = 0.f;
        for (int grp = 0; grp < 16; ++grp) {
            int e[8]; float gt[8];
#pragma unroll
            for (int q = 0; q < 8; ++q) { e[q] = __builtin_amdgcn_readfirstlane(EIDX[(size_t)t * 128 + grp * 8 + q]); gt[q] = GW[(size_t)t * 128 + grp * 8 + q]; }
            u32x4 ua[8], ub[8];
#pragma unroll
            for (int q = 0; q < 8; ++q) { const bf16* up = TU + (size_t)e[q] * D + 8 * lane; ua[q] = *(const u32x4*)up; ub[q] = *(const u32x4*)(up + 512); }
            u32x4 va[8], vb[8];
#pragma unroll
            for (int q = 0; q < 8; ++q) { const bf16* vp = TV + (size_t)e[q] * D + 8 * lane; va[q] = *(const u32x4*)vp; vb[q] = *(const u32x4*)(vp + 512); }
            float cf[8];
#pragma unroll
            for (int q = 0; q < 8; ++q) { float a[8], b[8]; unpack8(ua[q], a); unpack8(ub[q], b); float d = 0.f;
#pragma unroll
                for (int j = 0; j < 8; ++j) d += a[j] * xh[j] + b[j] * xh[8 + j];
                const float av = wave_sum(d) * rstd;
                cf[q] = gt[q] * 0.5f * av * (1.f + erff(av * 0.70710678118654752f)); }
#pragma unroll
            for (int q = 0; q < 8; ++q) { float a[8], b[8]; unpack8(va[q], a); unpack8(vb[q], b);
#pragma unroll
                for (int j = 0; j < 8; ++j) { y[j] += cf[q] * a[j]; y[8 + j] += cf[q] * b[j]; } }
        }
        float* o0 = out + (size_t)t * D + 8 * lane; float* o1 = o0 + 512;
        f32x4 r0 = *(const f32x4*)o0, r1 = *(const f32x4*)(o0 + 4), r2 = *(const f32x4*)o1, r3 = *(const f32x4*)(o1 + 4);
        r0[0] += y[0]; r0[1] += y[1]; r0[2] += y[2]; r0[3] += y[3]; r1[0] += y[4]; r1[1] += y[5]; r1[2] += y[6]; r1[3] += y[7];
        r2[0] += y[8]; r2[1] += y[9]; r2[2] += y[10]; r2[3] += y[11]; r3[0] += y[12]; r3[1] += y[13]; r3[2] += y[14]; r3[3] += y[15];
        *(f32x4*)o0 = r0; *(f32x4*)(o0 + 4) = r1; *(f32x4*)o1 = r2; *(f32x4*)(o1 + 4) = r3;
    }
}

#ifndef MK_N_LAUNCHES
#define MK_N_LAUNCHES 1
#endif
#ifndef MK_LAST_PHASE
#define MK_LAST_PHASE 11
#endif
constexpr int N_PHASES = 11;

__global__ void __launch_bounds__(512, 2) hybrid_fwd(Args args) {
    extern __shared__ __attribute__((aligned(16))) unsigned char lds_raw[];
    Frame F;
    F.lds = (LAS unsigned char*)lds_raw;
    F.tid = threadIdx.x; F.lane = F.tid & 63; F.wave = __builtin_amdgcn_readfirstlane(F.tid >> 6);
    F.bid = blockIdx.x; F.G = gridDim.x; F.ws = args.ws; F.dout = (unsigned char*)args.out;
    volatile LAS unsigned* MISC = (volatile LAS unsigned*)(F.lds + MISC_OFF);
    if (F.tid < 32) MISC[F.tid] = 0u;
    __syncthreads();
    unsigned* ctl = (unsigned*)(F.ws + WS_CTL);
    const int lo = args.ph_lo, hi = args.ph_hi;
    XcdBarrier bar; bar.bar = ctl + CW_BAR; bar.x = 0; bar.st = nullptr;
    if (hi - lo > 1) bar = xcd_barrier_post(ctl + CW_BAR, MISC + 8);
#ifndef PH_MASK
#define PH_MASK 0x7FF
#endif
#define IN(k) (((PH_MASK >> (k)) & 1) && lo <= (k) && (k) < hi)
#define SEAM(k) do { if (IN(k) && IN((k) + 1)) xcd_barrier(bar); } while (0)
    const bf16* XN = (const bf16*)(F.dout + DO_XN);

    if (IN(0)) { p0_prologue(F, args); SEAM(0); }

    if (IN(1)) {
        SchedGrid S{64, 16, F.G, F.bid, (const char*)XN, (const char*)(F.ws + WS_WIN), (size_t)256 * D * 2, (size_t)256 * D * 2};
        EpiStore E{(bf16*)(F.ws + WS_PROJ), NPA, 0};
        pg8::gemm_phase<EpiStore, SchedGrid, true>(F.lds, pg8::Gemm{D, D, D}, S, E);
        SEAM(1);
    }
    if (IN(2)) {
        { const int c = F.bid; SchedOne S{c < 16, c >> 2, c & 3, (const char*)(F.ws + WS_MEMN) + (size_t)(c >> 2) * 256 * D * 2, (const char*)(F.ws + WS_WKV) + (size_t)(c & 3) * 256 * D * 2};
          EpiStore E{(bf16*)(F.ws + WS_KVM), D, 0};
          pg8::gemm_phase<EpiStore, SchedOne, true>(F.lds, pg8::Gemm{D, D, D}, S, E); }
        for (int it = F.bid; it < 1024; it += F.G) gdn_prep_item(F, args, it);
        SEAM(2);
    }
    if (IN(3)) {
        if (F.bid < 128) gdn_scan_item(F, F.bid);
        for (;;) {
            __syncthreads();
            if (F.tid == 0) MISC[16] = atomicAdd(ctl + CW_QUEUE, 1u);
            __syncthreads();
            const int item = (int)MISC[16];
            if (item >= 1024) break;
            attn_dispatch(F, args, item);
        }
        SEAM(3);
    }
    if (IN(4)) { p3b_phase(F, args); SEAM(4); }
    if (IN(5)) {
        SchedGrid S{64, 12, F.G, F.bid, (const char*)XN, (const char*)(F.ws + WS_WIN) + (size_t)4096 * D * 2, (size_t)256 * D * 2, (size_t)256 * D * 2};
        EpiStore E{(bf16*)(F.ws + WS_GATES), NG, 1};
        pg8::gemm_phase<EpiStore, SchedGrid, true>(F.lds, pg8::Gemm{D, D, D}, S, E);
        SEAM(5);
    }
    if (IN(6)) {
        SchedBranch S{F.G, F.bid, (const char*)(F.dout + DO_OA), (long)((const char*)(F.ws + WS_OB1) - (const char*)(F.dout + DO_OA)), (long)((const char*)(F.dout + DO_OM) - (const char*)(F.dout + DO_OA)), (const char*)(F.ws + WS_WBR)};
        EpiBranch E{(const bf16*)(F.ws + WS_GATES), (bf16*)(F.ws + WS_MERGED)};
        pg8::gemm_phase<EpiBranch, SchedBranch, true>(F.lds, pg8::Gemm{512, 512, 512}, S, E);
        SEAM(6);
    }
    if (IN(7)) {
        SchedGrid S{64, 4, F.G, F.bid, (const char*)(F.ws + WS_MERGED), (const char*)(F.ws + WS_WOUT), (size_t)256 * D * 2, (size_t)256 * D * 2};
        EpiOut E{args.in[0], args.out, (bf16*)(F.ws + WS_HB), (float*)(F.ws + WS_CTL) + CW_ROWSS};
        pg8::gemm_phase<EpiOut, SchedGrid, true>(F.lds, pg8::Gemm{D, D, D}, S, E);
        SEAM(7);
    }
    if (IN(8)) {
        SchedGrid S{64, 8, F.G, F.bid, (const char*)(F.ws + WS_HB), (const char*)(F.ws + WS_WQ), (size_t)256 * D * 2, (size_t)256 * D * 2};
        EpiQry E{(const float*)(F.ws + WS_CTL) + CW_ROWSS, (bf16*)(F.ws + WS_QRY)};
        pg8::gemm_phase<EpiQry, SchedGrid, true>(F.lds, pg8::Gemm{D, D, D}, S, E);
        SEAM(8);
    }
    if (IN(9)) { peer_route_phase(F); SEAM(9); }
    if (IN(10)) { peer_gather_phase(F, args.out); }
#undef IN
#undef SEAM
}

extern "C" void kernel_launch(void* const* d_in, const int* in_sizes, int n_in, void* d_out, int out_size, void* d_ws, size_t ws_size, hipStream_t stream) {
    static int grid = 0;
    if (grid == 0) {
        if (n_in != 22 || in_sizes[0] != T * D || out_size != T * D || ws_size < WS_END) {
            fprintf(stderr, "kernel_launch: unexpected shapes: n_in %d in0 %d out %d ws %zu; nothing launched\n", n_in, n_in > 0 ? in_sizes[0] : -1, out_size, ws_size); grid = -1; return; }
        int dev = 0, cus = 0, per_cu = 0;
        if (hipGetDevice(&dev) != hipSuccess || hipDeviceGetAttribute(&cus, hipDeviceAttributeMultiprocessorCount, dev) != hipSuccess) { grid = -1; return; }
        if (hipFuncSetAttribute((const void*)hybrid_fwd, hipFuncAttributeMaxDynamicSharedMemorySize, LDS_BYTES) != hipSuccess) { fprintf(stderr, "kernel_launch: hipFuncSetAttribute failed\n"); grid = -1; return; }
        if (hipOccupancyMaxActiveBlocksPerMultiprocessor(&per_cu, (const void*)hybrid_fwd, 512, LDS_BYTES) != hipSuccess || per_cu < 1) {
            fprintf(stderr, "kernel_launch: occupancy query reports %d workgroups per CU\n", per_cu); (void)hipGetLastError(); }
        grid = cus;
    }
    if (grid < 0) return;
    if (hipMemsetAsync((char*)d_ws + WS_CTL, 0, CTL_ZERO_BYTES, stream) != hipSuccess) { fprintf(stderr, "kernel_launch: memset failed\n"); return; }
    Args a{};
    for (int i = 0; i < 22; ++i) a.in[i] = (const float*)d_in[i];
    a.out = (float*)d_out; a.ws = (unsigned char*)d_ws;
#if MK_N_LAUNCHES == 1
    a.ph_lo = 0; a.ph_hi = MK_LAST_PHASE;
    hipLaunchKernelGGL(hybrid_fwd, dim3(grid), dim3(512), LDS_BYTES, stream, a);
#else
    for (int p = 0; p < MK_LAST_PHASE; ++p) { a.ph_lo = p; a.ph_hi = p + 1; hipLaunchKernelGGL(hybrid_fwd, dim3(grid), dim3(512), LDS_BYTES, stream, a); }
#endif
}
```
